# Optimizing an MI355X kernel written in HIP

```python
import jax, jax.numpy as jnp
from jax import lax
import numpy as np

D_MODEL = 1024
BATCH = 8
SEQ = 4096
DEPTH = 2

N_MIXERS = 2
ATTN_PAIRS = ((128, 1), (512, 4), (2048, 16))
N_ATTN_GROUPS = len(ATTN_PAIRS)
HEADS_PER_GROUP = 8
HEAD_DIM = D_MODEL // HEADS_PER_GROUP
ATTN_WIDTH = HEADS_PER_GROUP * HEAD_DIM
QKV_WIDTH = N_ATTN_GROUPS * 3 * ATTN_WIDTH
N_ALIBI_HEADS = N_ATTN_GROUPS * HEADS_PER_GROUP
Q_BLOCK = 128
POOL_WINDOWS = (2, 4, 8, 16)
POOL_GROUPS = len(POOL_WINDOWS)
POOL_GROUP_DIM = D_MODEL // POOL_GROUPS
D_FF = ((8 * D_MODEL + 3 * 256 - 1) // (3 * 256)) * 256
N_ATTN_LAYERS = (DEPTH + 1) // 2
N_POOL_LAYERS = DEPTH // 2
RMS_EPS = 1e-6

kernel_name = "dilated_attn_pool_hybrid_trunk"


def rmsnorm(x, g):
    xf = x.astype(jnp.float32)
    y = xf * lax.rsqrt(jnp.mean(xf * xf, axis=-1, keepdims=True) + RMS_EPS)
    return (y * g.astype(jnp.float32)).astype(x.dtype)


def alibi_slopes():
    n = N_ALIBI_HEADS
    return jnp.exp2(-8.0 * jnp.arange(1, n + 1, dtype=jnp.float32) / n)


def dilated_window_attention(q, k, v, window, dil, slopes):
    B, S, H, D = q.shape
    L = S // dil
    w_sub = window // dil
    nb = -(-L // Q_BLOCK)
    Lp = nb * Q_BLOCK
    pad = Lp - L
    Bd = B * dil

    def fold(a):
        return a.reshape(B, L, dil, H, D).transpose(0, 2, 1, 3, 4).reshape(Bd, L, H, D)

    def band(a):
        a = jnp.pad(a, ((0, 0), (Q_BLOCK, pad), (0, 0), (0, 0))).reshape(Bd, nb + 1, Q_BLOCK, H, D)
        return jnp.concatenate([a[:, :-1], a[:, 1:]], axis=2)

    qb = jnp.pad(fold(q), ((0, 0), (0, pad), (0, 0), (0, 0))).reshape(Bd, nb, Q_BLOCK, H, D)
    kb = band(fold(k))
    vb = band(fold(v))

    s = jnp.einsum('bnqhd,bnkhd->bnhqk', qb, kb) * (D ** -0.5)
    qi = jnp.arange(Q_BLOCK)[:, None]
    ki = jnp.arange(2 * Q_BLOCK)[None, :]
    delta = Q_BLOCK + qi - ki
    blk = jnp.arange(nb)[:, None, None]
    key_idx = blk * Q_BLOCK + ki[None] - Q_BLOCK
    valid = (delta >= 0)[None] & (delta <= w_sub)[None] & (key_idx >= 0)
    bias = -slopes[:, None, None] * (delta * dil).astype(jnp.float32)[None]
    s = s + bias[None, None]
    s = jnp.where(valid[None, :, None], s, -jnp.inf)
    m = jnp.max(s, axis=-1, keepdims=True)
    p = jnp.exp(s - m)
    den = jnp.sum(p, axis=-1, keepdims=True)
    o = jnp.einsum('bnhqk,bnkhd->bnqhd', p / den, vb)
    lse = (m + jnp.log(den))[..., 0].transpose(0, 1, 3, 2)

    o = o.reshape(Bd, Lp, H, D)[:, :L]
    o = o.reshape(B, dil, L, H, D).transpose(0, 2, 1, 3, 4).reshape(B, S, H, D)
    lse = lse.reshape(Bd, Lp, H)[:, :L]
    lse = lse.reshape(B, dil, L, H).transpose(0, 2, 1, 3).reshape(B, S, H)
    return o, lse


def dilated_attention_mixer(h, w_qkv, w_out):
    B, S, _ = h.shape
    qkv = (h @ w_qkv).astype(jnp.float32).reshape(B, S, N_ATTN_GROUPS, 3, HEADS_PER_GROUP, HEAD_DIM)
    slopes = alibi_slopes().reshape(N_ATTN_GROUPS, HEADS_PER_GROUP)
    outs, lses = [], []
    for g, (window, dil) in enumerate(ATTN_PAIRS):
        o, lse = dilated_window_attention(qkv[:, :, g, 0], qkv[:, :, g, 1], qkv[:, :, g, 2], window, dil, slopes[g])
        outs.append(o)
        lses.append(lse)
    o = jnp.stack(outs, axis=0)
    wts = jax.nn.softmax(jnp.stack(lses, axis=0), axis=0)
    o = jnp.sum(wts[..., None] * o, axis=0).reshape(B, S, ATTN_WIDTH)
    return o.astype(h.dtype) @ w_out


def trailing_mean(u, w):
    B, S, C = u.shape
    c = jnp.cumsum(u, axis=1)
    shifted = jnp.concatenate([jnp.zeros((B, w, C), u.dtype), c[:, :S - w]], axis=1)
    count = jnp.minimum(jnp.arange(1, S + 1), w).astype(jnp.float32)[None, :, None]
    return (c - shifted) / count


def pooling_mixer(h, w_in, w_group, scale):
    B, S, _ = h.shape
    u = (h @ w_in).astype(jnp.float32).reshape(B, S, POOL_GROUPS, POOL_GROUP_DIM)
    ys = [trailing_mean(u[:, :, g], w) - u[:, :, g] for g, w in enumerate(POOL_WINDOWS)]
    y = jnp.stack(ys, axis=2)
    y = jnp.einsum('bsgc,gcd->bsgd', y, w_group.astype(jnp.float32)).reshape(B, S, D_MODEL)
    return (y * scale.astype(jnp.float32)).astype(h.dtype)


def swiglu_ffn(h, w_gate_up, w_down):
    gu = h @ w_gate_up
    gate, up = gu[..., :D_FF], gu[..., D_FF:]
    return (jax.nn.silu(gate) * up) @ w_down


def setup_inputs(seed: int = 0) -> dict:
    key = jax.random.key(seed)
    ks = jax.random.split(key, 13)
    f32 = jnp.float32
    nA, nP = N_ATTN_LAYERS, N_POOL_LAYERS
    return {
        "x": jax.random.normal(ks[0], (BATCH, SEQ, D_MODEL), f32),
        "attn_norm": 1.0 + 0.02 * jax.random.normal(ks[1], (nA, D_MODEL), f32),
        "w_qkv": jax.random.normal(ks[2], (nA, D_MODEL, QKV_WIDTH), f32) * D_MODEL ** -0.5,
        "w_attn_out": jax.random.normal(ks[3], (nA, ATTN_WIDTH, D_MODEL), f32) * ATTN_WIDTH ** -0.5,
        "pool_norm": 1.0 + 0.02 * jax.random.normal(ks[4], (nP, D_MODEL), f32),
        "w_pool_in": jax.random.normal(ks[5], (nP, D_MODEL, D_MODEL), f32) * D_MODEL ** -0.5,
        "w_pool_group": jax.random.normal(ks[6], (nP, POOL_GROUPS, POOL_GROUP_DIM, POOL_GROUP_DIM), f32) * POOL_GROUP_DIM ** -0.5,
        "pool_scale": 0.5 + 0.1 * jax.random.normal(ks[7], (nP, D_MODEL), f32),
        "ffn_norm": 1.0 + 0.02 * jax.random.normal(ks[8], (DEPTH, D_MODEL), f32),
        "w_ffn_gate_up": jax.random.normal(ks[9], (DEPTH, D_MODEL, 2 * D_FF), f32) * D_MODEL ** -0.5,
        "w_ffn_down": jax.random.normal(ks[10], (DEPTH, D_FF, D_MODEL), f32) * D_FF ** -0.5,
        "final_norm": 1.0 + 0.02 * jax.random.normal(ks[11], (D_MODEL,), f32),
    }


def reference(x, attn_norm, w_qkv, w_attn_out, pool_norm, w_pool_in, w_pool_group, pool_scale,
              ffn_norm, w_ffn_gate_up, w_ffn_down, final_norm):
    for i in range(DEPTH):
        j = i // N_MIXERS
        if i % N_MIXERS == 0:
            x = x + dilated_attention_mixer(rmsnorm(x, attn_norm[j]), w_qkv[j], w_attn_out[j])
        else:
            x = x + pooling_mixer(rmsnorm(x, pool_norm[j]), w_pool_in[j], w_pool_group[j], pool_scale[j])
        x = x + swiglu_ffn(rmsnorm(x, ffn_norm[i]), w_ffn_gate_up[i], w_ffn_down[i])
    return rmsnorm(x, final_norm)
```

```cpp
#include <hip/hip_runtime.h>
#include <hip/hip_cooperative_groups.h>
#include <cstdio>
#include <cstdint>
namespace cg = cooperative_groups;
namespace pg8 {
#define PG8_LAS __attribute__((address_space(3)))
typedef unsigned short bf16_t;
typedef short bf16x8 __attribute__((ext_vector_type(8)));
typedef float f32x4 __attribute__((ext_vector_type(4)));
typedef unsigned u32x4 __attribute__((ext_vector_type(4)));
constexpr int BM = 256, BK = 64, HALF = 128, HTB = HALF * BK * 2  , STAGE_BYTES = 8 * HTB, NXCD = 8, WGM = 8;

__host__ __device__ __forceinline__ int lds_byte(int r, int c) { const int st = (r >> 4) * 2 + (c >> 5), rr = r & 15, cc = c & 31, ob = rr * 64 + cc * 2; return st * 1024 + (ob ^ (((ob >> 9) & 1) << 5)); }
__host__ __device__ __forceinline__ void stage_rc(int b, int& R, int& C) { const int st = b / 1024, sb = b % 1024, swz = sb ^ (((sb >> 9) & 1) << 5); R = (st >> 1) * 16 + swz / 64; C = (st & 1) * 32 + (swz % 64) / 2; }
__host__ __device__ __forceinline__ int perm32(int rho) { const int n = rho >> 4, i = rho & 15; return 8 * (i >> 2) + 4 * n + (i & 3); }

struct Unit { int pm, pn; };
struct Gemm { const bf16_t* A; const bf16_t* Bt; int M, N, K, lda, a_pn_off; };

struct StaticOrder {
    int nM, nN, nwg, G, c;
    __host__ __device__ void init(int M, int N, int G_, int c_) { nM = M / BM; nN = N / BM; nwg = nM * nN; G = G_; c = c_; }
    __host__ __device__ bool next(int i, Unit& u) const {
        const long L = (long)i * G + c; if (L >= nwg) return false;
        int wgid = (int)L; { const int q = nwg / NXCD, r = nwg % NXCD, xcd = wgid % NXCD, off = wgid / NXCD; wgid = (xcd < r ? xcd * (q + 1) : r * (q + 1) + (xcd - r) * q) + off; }
        const int nig = WGM * nN, gid = wgid / nig, fm = gid * WGM, gsz = (nM - fm) < WGM ? (nM - fm) : WGM;
        u.pm = fm + ((wgid % nig) % gsz); u.pn = (wgid % nig) / gsz; return true;
    }
    __device__ __forceinline__ void a_ready(const Unit&) const {}
    __device__ __forceinline__ void done(const Unit&) const {}
};

__device__ __forceinline__ unsigned cvt_pk_bf16(float lo, float hi) { unsigned r; asm volatile("v_cvt_pk_bf16_f32 %0, %1, %2" : "=v"(r) : "v"(lo), "v"(hi)); return r; }
typedef float f32x2 __attribute__((ext_vector_type(2)));

constexpr float RMS_EPS_F = 1e-6f;
__device__ __forceinline__ float rstd_from_slots(const float* slots, int row, int fq) {
    const f32x4 s4 = *(const f32x4*)(slots + (size_t)row * 16 + 4 * fq);
    float s = (s4[0] + s4[1]) + (s4[2] + s4[3]);
    s += __shfl_xor(s, 16); s += __shfl_xor(s, 32);
    return __builtin_amdgcn_rsqf(s * (1.0f / 1024.0f) + RMS_EPS_F);
}
struct EpiBf16S {
    static constexpr bool PERM = true, AFTER_DRAIN = false;
    bf16_t* O; int ldc; const float* slots;
    __device__ __forceinline__ void operator()(const f32x4 (&acc)[2][2][4][2], const Unit& u, int wr, int wc, int fr, int fq) const {
        const int row0 = u.pm * BM + wr * 64 + fr; const int col0 = u.pn * BM + wc * 32 + 8 * fq;
#pragma unroll
        for (int ai = 0; ai < 2; ++ai)
#pragma unroll
            for (int m = 0; m < 4; ++m) { const int row = row0 + ai * HALF + m * 16; bf16_t* rowp = O + (size_t)row * ldc + col0;
                const float sc = slots ? rstd_from_slots(slots, row, fq) : 1.0f;
#pragma unroll
                for (int bj = 0; bj < 2; ++bj) { const f32x4 v0 = acc[ai][bj][m][0] * sc, v1 = acc[ai][bj][m][1] * sc;
                    u32x4 w; w.x = cvt_pk_bf16(v0[0], v0[1]); w.y = cvt_pk_bf16(v0[2], v0[3]); w.z = cvt_pk_bf16(v1[0], v1[1]); w.w = cvt_pk_bf16(v1[2], v1[3]);
                    *(u32x4*)(rowp + bj * HALF) = w; } }
    }
};
__device__ __forceinline__ float silu_mul(float g, float u) { return g * u * __builtin_amdgcn_rcpf(1.0f + __builtin_amdgcn_exp2f(g * -1.4426950408889634f)); }
struct EpiSwiGLU {
    static constexpr bool PERM = true, AFTER_DRAIN = false;
    bf16_t* O; int ldc; const float* slots;
    __device__ __forceinline__ void operator()(const f32x4 (&acc)[2][2][4][2], const Unit& u, int wr, int wc, int fr, int fq) const {
        const int row0 = u.pm * BM + wr * 64 + fr; const int col0 = u.pn * HALF + wc * 32 + 8 * fq;
#pragma unroll
        for (int ai = 0; ai < 2; ++ai)
#pragma unroll
            for (int m = 0; m < 4; ++m) { const int row = row0 + ai * HALF + m * 16;
                const float sc = rstd_from_slots(slots, row, fq);
                const f32x4 g0 = acc[ai][0][m][0] * sc, g1 = acc[ai][0][m][1] * sc, u0 = acc[ai][1][m][0] * sc, u1 = acc[ai][1][m][1] * sc;
                u32x4 w; w.x = cvt_pk_bf16(silu_mul(g0[0], u0[0]), silu_mul(g0[1], u0[1])); w.y = cvt_pk_bf16(silu_mul(g0[2], u0[2]), silu_mul(g0[3], u0[3]));
                w.z = cvt_pk_bf16(silu_mul(g1[0], u1[0]), silu_mul(g1[1], u1[1])); w.w = cvt_pk_bf16(silu_mul(g1[2], u1[2]), silu_mul(g1[3], u1[3]));
                *(u32x4*)(O + (size_t)row * ldc + col0) = w; }
    }
};
struct EpiRes {
    static constexpr bool PERM = false, AFTER_DRAIN = false;
    const float* base; float* out; bf16_t* xb; float* slots;
    __device__ __forceinline__ void operator()(const f32x4 (&acc)[2][2][4][2], const Unit& u, int wr, int wc, int fr, int fq) const {
        typedef unsigned u32x2v __attribute__((ext_vector_type(2)));
        const int col0 = u.pn * BM + wc * 32 + 4 * fq;
#pragma unroll
        for (int ai = 0; ai < 2; ++ai)
#pragma unroll
            for (int m = 0; m < 4; ++m) { const int row = u.pm * BM + ai * HALF + wr * 64 + m * 16 + fr; const size_t off = (size_t)row * 1024 + col0; float ss = 0.f;
#pragma unroll
                for (int bj = 0; bj < 2; ++bj)
#pragma unroll
                    for (int n = 0; n < 2; ++n) { const f32x4 bs = *(const f32x4*)(base + off + bj * HALF + n * 16); const f32x4 o = bs + acc[ai][bj][m][n];
                        *(f32x4*)(out + off + bj * HALF + n * 16) = o; ss += (o[0] * o[0] + o[1] * o[1]) + (o[2] * o[2] + o[3] * o[3]);
                        if (xb) { u32x2v w; w.x = cvt_pk_bf16(o[0], o[1]); w.y = cvt_pk_bf16(o[2], o[3]); *(u32x2v*)(xb + off + bj * HALF + n * 16) = w; } }
                if (slots) { ss += __shfl_xor(ss, 16); ss += __shfl_xor(ss, 32); if (fq == 0) slots[(size_t)row * 16 + u.pn * 4 + wc] = ss; }
                if (m & 1) asm volatile("" ::: "memory"); }
    }
};

template <class Epi, class Sched, bool ALIGN_EPI = false, bool SP2 = false>
__device__ __forceinline__ void gemm_phase(PG8_LAS unsigned char* lds, const Gemm g, const Sched& S, const Epi& E) {
    const int tid = threadIdx.x, wid = __builtin_amdgcn_readfirstlane(tid >> 6), lane = tid & 63, wr = wid >> 2, wc = wid & 3, fr = lane & 15, fq = lane >> 4;
    const int K = g.K, nt = K / BK, lda = g.lda;
    unsigned voffA[2], voffB[2];
#pragma unroll
    for (int i = 0; i < 2; ++i) { int R, C; stage_rc(tid * 16 + i * 8192, R, C); const int Rb = Epi::PERM ? ((R & ~31) + perm32(R & 31)) : R;
        voffA[i] = (unsigned)(R * lda + C) * 2u; voffB[i] = (unsigned)(Rb * K + C) * 2u; }
    const size_t kstep = (size_t)(BK * 2);
    const size_t hstepA = (size_t)HALF * lda * 2, hstepB = (size_t)HALF * K * 2;
    const size_t tstepA = 2 * hstepA, tstepB = 2 * hstepB;
    const size_t apn = (size_t)g.a_pn_off * 2;
    const unsigned ldsw = (unsigned)wid * 1024u;
    const int aoff = lds_byte(wr * 64 + fr, fq * 8), boff = lds_byte(wc * 32 + fr, fq * 8);
#define PG8_SA(b, h) (((b) * 2 + (h)) * HTB)
#define PG8_SB(b, h) ((4 + (b) * 2 + (h)) * HTB)
#define PG8_STAGE(bufoff, gbase, voff) do { _Pragma("unroll") for (int _i = 0; _i < 2; ++_i) \
        __builtin_amdgcn_global_load_lds((const unsigned*)((const char*)(gbase) + (voff)[_i]), (PG8_LAS unsigned*)(lds + (bufoff) + ldsw + _i * 8192), 16, 0, 0); } while (0)
#define PG8_LDA(dst, b, h) do { _Pragma("unroll") for (int m = 0; m < 4; ++m) _Pragma("unroll") for (int k = 0; k < 2; ++k) dst[m][k] = *(const PG8_LAS bf16x8*)(lds + PG8_SA(b, h) + aoff + m * 2048 + k * 1024); } while (0)
#define PG8_LDB(dst, b, h) do { _Pragma("unroll") for (int n = 0; n < 2; ++n) _Pragma("unroll") for (int k = 0; k < 2; ++k) dst[n][k] = *(const PG8_LAS bf16x8*)(lds + PG8_SB(b, h) + boff + n * 2048 + k * 1024); } while (0)
#define PG8_MMA(ai, bj, At, Bt) do { __builtin_amdgcn_s_setprio(1); _Pragma("unroll") for (int m = 0; m < 4; ++m) _Pragma("unroll") for (int n = 0; n < 2; ++n) _Pragma("unroll") for (int k = 0; k < 2; ++k) \
        acc[ai][bj][m][n] = __builtin_amdgcn_mfma_f32_16x16x32_bf16(Bt[n][k], At[m][k], acc[ai][bj][m][n], 0, 0, 0); __builtin_amdgcn_s_setprio(0); } while (0)
#define PG8_WAIT_V(n) asm volatile("s_waitcnt vmcnt(" #n ")" ::: "memory")
#define PG8_WAIT_L(n) asm volatile("s_waitcnt lgkmcnt(" #n ")" ::: "memory")
#define PG8_BAR __builtin_amdgcn_s_barrier()
#define PG8_SCHED __builtin_amdgcn_sched_barrier(0)
    Unit cur, nxt; int ui = 0;
    if (!S.next(0, cur)) return;
    f32x4 acc[2][2][4][2];
#pragma unroll
    for (int a = 0; a < 2; ++a)
#pragma unroll
        for (int b = 0; b < 2; ++b)
#pragma unroll
            for (int m = 0; m < 4; ++m)
#pragma unroll
                for (int n = 0; n < 2; ++n) acc[a][b][m][n] = (f32x4){0.f, 0.f, 0.f, 0.f};
    bf16x8 At[4][2], B0[2][2], B1[2][2];
    const char* cA = (const char*)g.A + (size_t)cur.pm * tstepA + (size_t)cur.pn * apn; const char* cB = (const char*)g.Bt + (size_t)cur.pn * tstepB;
    S.a_ready(cur);
    if constexpr (SP2) {
        PG8_STAGE(PG8_SB(0, 0), cB, voffB); PG8_STAGE(PG8_SB(0, 1), cB + hstepB, voffB); PG8_STAGE(PG8_SA(0, 0), cA, voffA); PG8_STAGE(PG8_SA(0, 1), cA + hstepA, voffA);
        if (wr == 1) PG8_BAR;
        PG8_WAIT_V(2); PG8_BAR;
        PG8_STAGE(PG8_SB(1, 0), cB + kstep, voffB); PG8_STAGE(PG8_SA(1, 0), cA + kstep, voffA); PG8_STAGE(PG8_SB(1, 1), cB + hstepB + kstep, voffB);
        PG8_WAIT_V(6); PG8_BAR;
    } else {
        PG8_STAGE(PG8_SB(0, 0), cB, voffB); PG8_STAGE(PG8_SA(0, 0), cA, voffA); PG8_STAGE(PG8_SB(0, 1), cB + hstepB, voffB); PG8_STAGE(PG8_SA(0, 1), cA + hstepA, voffA);
        if (wr == 1) PG8_BAR;
        PG8_WAIT_V(4); PG8_BAR;
        PG8_STAGE(PG8_SB(1, 0), cB + kstep, voffB); PG8_STAGE(PG8_SA(1, 0), cA + kstep, voffA); PG8_STAGE(PG8_SB(1, 1), cB + hstepB + kstep, voffB);
        PG8_WAIT_V(6); PG8_BAR;
    }
    for (;;) {
        const bool has_next = S.next(ui + 1, nxt);
        const char* nA = has_next ? (const char*)g.A + (size_t)nxt.pm * tstepA + (size_t)nxt.pn * apn : cA; const char* nB = has_next ? (const char*)g.Bt + (size_t)nxt.pn * tstepB : cB;
        for (int t = 0; t < nt; t += 2) {
            const bool last = (t == nt - 2);
            const char* a1 = cA + (size_t)(t + 1) * kstep;
            const char* a2 = last ? nA : cA + (size_t)(t + 2) * kstep; const char* b2 = last ? nB : cB + (size_t)(t + 2) * kstep;
            const char* a3 = a2 + kstep; const char* b3 = b2 + kstep;
            if (last && has_next) S.a_ready(nxt);
            if constexpr (SP2) {
            PG8_LDB(B0, 0, 0); PG8_LDB(B1, 0, 1); PG8_SCHED; PG8_LDA(At, 0, 0); PG8_STAGE(PG8_SA(1, 1), a1 + hstepA, voffA);
            PG8_WAIT_V(8); PG8_WAIT_L(0); PG8_BAR; PG8_MMA(0, 0, At, B0); PG8_MMA(0, 1, At, B1); PG8_BAR; PG8_SCHED;
            PG8_LDA(At, 0, 1); PG8_STAGE(PG8_SB(0, 0), b2, voffB); PG8_STAGE(PG8_SB(0, 1), b2 + hstepB, voffB); PG8_STAGE(PG8_SA(0, 0), a2, voffA);
            PG8_WAIT_V(8); PG8_WAIT_L(0); PG8_BAR; PG8_MMA(1, 0, At, B0); PG8_MMA(1, 1, At, B1); PG8_BAR; PG8_SCHED;
            PG8_LDB(B0, 1, 0); PG8_LDB(B1, 1, 1); PG8_SCHED; PG8_LDA(At, 1, 0); PG8_STAGE(PG8_SA(0, 1), a2 + hstepA, voffA);
            PG8_WAIT_V(8); PG8_WAIT_L(0); PG8_BAR; PG8_MMA(0, 0, At, B0); PG8_MMA(0, 1, At, B1); PG8_BAR; PG8_SCHED;
            PG8_LDA(At, 1, 1); PG8_STAGE(PG8_SB(1, 0), b3, voffB); PG8_STAGE(PG8_SB(1, 1), b3 + hstepB, voffB); PG8_STAGE(PG8_SA(1, 0), a3, voffA);
            PG8_WAIT_V(8); PG8_WAIT_L(0); PG8_BAR; PG8_MMA(1, 0, At, B0); PG8_MMA(1, 1, At, B1); PG8_BAR; PG8_SCHED;
            } else {
            PG8_LDB(B0, 0, 0); PG8_SCHED; PG8_LDA(At, 0, 0); PG8_STAGE(PG8_SA(1, 1), a1 + hstepA, voffA);
            PG8_WAIT_L(8); PG8_BAR; PG8_WAIT_L(0); PG8_MMA(0, 0, At, B0); PG8_BAR; PG8_SCHED;
            PG8_LDB(B1, 0, 1); PG8_STAGE(PG8_SB(0, 0), b2, voffB);
            PG8_BAR; PG8_WAIT_L(0); PG8_MMA(0, 1, At, B1); PG8_BAR;
            PG8_LDA(At, 0, 1); PG8_STAGE(PG8_SA(0, 0), a2, voffA);
            PG8_BAR; PG8_WAIT_L(0); PG8_MMA(1, 0, At, B0); PG8_BAR; PG8_SCHED;
            PG8_STAGE(PG8_SB(0, 1), b2 + hstepB, voffB);
            PG8_WAIT_V(6); PG8_BAR; PG8_MMA(1, 1, At, B1); PG8_BAR;
            PG8_LDB(B0, 1, 0); PG8_SCHED; PG8_LDA(At, 1, 0); PG8_STAGE(PG8_SA(0, 1), a2 + hstepA, voffA);
            PG8_WAIT_L(8); PG8_BAR; PG8_WAIT_L(0); PG8_MMA(0, 0, At, B0); PG8_BAR; PG8_SCHED;
            PG8_LDB(B1, 1, 1); PG8_STAGE(PG8_SB(1, 0), b3, voffB);
            PG8_BAR; PG8_WAIT_L(0); PG8_MMA(0, 1, At, B1); PG8_BAR;
            PG8_LDA(At, 1, 1); PG8_STAGE(PG8_SA(1, 0), a3, voffA);
            PG8_BAR; PG8_WAIT_L(0); PG8_MMA(1, 0, At, B0); PG8_BAR; PG8_SCHED;
            PG8_STAGE(PG8_SB(1, 1), b3 + hstepB, voffB);
            PG8_WAIT_V(6); PG8_BAR; PG8_MMA(1, 1, At, B1); PG8_BAR;
            }
        }
        if constexpr (ALIGN_EPI) { if (wr == 0) PG8_BAR; }
        if constexpr (!Epi::AFTER_DRAIN) { E(acc, cur, wr, wc, fr, fq); S.done(cur); }
        if (!has_next) break;
#pragma unroll
        for (int a = 0; a < 2; ++a)
#pragma unroll
            for (int b = 0; b < 2; ++b)
#pragma unroll
                for (int m = 0; m < 4; ++m)
#pragma unroll
                    for (int n = 0; n < 2; ++n) acc[a][b][m][n] = (f32x4){0.f, 0.f, 0.f, 0.f};
        cur = nxt; cA = nA; cB = nB; ++ui;
        if constexpr (ALIGN_EPI) { if (wr == 1) PG8_BAR; }
    }
    PG8_WAIT_V(0);
    if constexpr (!ALIGN_EPI) { if (wr == 0) PG8_BAR; }
    PG8_BAR;
    if constexpr (Epi::AFTER_DRAIN) { E.fused(acc, cur, wr, wc, fr, fq, lds, wid, lane); S.done(cur); }
#undef PG8_SA
#undef PG8_SB
#undef PG8_STAGE
#undef PG8_LDA
#undef PG8_LDB
#undef PG8_MMA
#undef PG8_WAIT_V
#undef PG8_WAIT_L
#undef PG8_BAR
#undef PG8_SCHED
}
}


constexpr int D = 1024, SEQ = 4096, BATCH = 8, M = BATCH * SEQ, MH = M / 2, NQKV = 9216, DFF = 2816, NGU = 2 * DFF;
constexpr int NWAVES = 8, NTHREADS = NWAVES * 64;
#ifndef MK_N_LAUNCHES
#define MK_N_LAUNCHES 15
#endif
constexpr int N_PHASES = 15;

#define LAS __attribute__((address_space(3)))
typedef unsigned short bf16;
typedef unsigned v4u __attribute__((ext_vector_type(4)));
typedef unsigned v2u __attribute__((ext_vector_type(2)));
typedef float f32x4 __attribute__((ext_vector_type(4)));
typedef short bf16x8 __attribute__((ext_vector_type(8)));
typedef short s16x4 __attribute__((ext_vector_type(4)));

constexpr size_t MiB = 1u << 20;
constexpr size_t WS_SLOTS = 0;
constexpr size_t WS_LSE = 2 * MiB;
constexpr size_t WS_WQKV = 4 * MiB;
constexpr size_t WS_WOUT = 22 * MiB;
constexpr size_t WS_WPIN = 24 * MiB;
constexpr size_t WS_WG = 26 * MiB;
constexpr size_t WS_WGU = 27 * MiB;
constexpr size_t WS_WDN = 49 * MiB;
constexpr size_t WS_XN = 60 * MiB;
constexpr size_t WS_BIG = 124 * MiB;
constexpr size_t WS_XB = WS_BIG, WS_H = WS_BIG + 64 * MiB, WS_Y = WS_H;
constexpr size_t WS_END = 412 * MiB;

constexpr int RING_BYTES = 131072, LDS_BYTES = 147456;

__device__ __forceinline__ unsigned cvtpk(float lo, float hi) { unsigned r; asm volatile("v_cvt_pk_bf16_f32 %0, %1, %2" : "=v"(r) : "v"(lo), "v"(hi)); return r; }
__device__ __forceinline__ float bflo(unsigned u) { return __uint_as_float(u << 16); }
__device__ __forceinline__ float bfhi(unsigned u) { return __uint_as_float(u & 0xffff0000u); }
__device__ __forceinline__ float wave_sum(float v) {
#pragma unroll
    for (int o = 1; o < 64; o <<= 1) v += __shfl_xor(v, o);
    return v;
}

constexpr float QSCALE = 0.08838834764831845f * 1.4426950408889634f;
__device__ __forceinline__ void transpose_item(const float* __restrict__ W, int K, int N, bf16* __restrict__ WT, const float* __restrict__ kgain, int mode, const float* __restrict__ cs,
                                               LAS float* scr, int item, int lane) {
    const int nblk = N / 32, kb = item / nblk, nb = item % nblk, k0 = 64 * kb, n0 = 32 * nb;
#pragma unroll 8
    for (int i = 0; i < 32; ++i) { const int kk = 2 * i + (lane >> 5); float v = W[(size_t)(k0 + kk) * N + n0 + (lane & 31)]; if (kgain) v *= kgain[k0 + kk]; scr[kk * 33 + (lane & 31)] = v; }
    asm volatile("s_waitcnt lgkmcnt(0)" ::: "memory");
    int orow0 = n0; float usc = 1.0f;
    if (mode == 1) { if ((n0 % 3072) < 1024) usc = QSCALE; }
    else if (mode == 2) { if (n0 < DFF) orow0 = 256 * (n0 / 128) + (n0 % 128); else { const int j = n0 - DFF; orow0 = 256 * (j / 128) + 128 + (j % 128); } }
    const int c = lane & 7;
#pragma unroll
    for (int j = 0; j < 4; ++j) { const int n = (lane >> 3) + 8 * j; const LAS float* s = scr + (8 * c) * 33 + n;
        const float sc = (mode == 3) ? cs[n0 + n] : usc;
        v4u o; o.x = cvtpk(s[0 * 33] * sc, s[1 * 33] * sc); o.y = cvtpk(s[2 * 33] * sc, s[3 * 33] * sc); o.z = cvtpk(s[4 * 33] * sc, s[5 * 33] * sc); o.w = cvtpk(s[6 * 33] * sc, s[7 * 33] * sc);
        *(v4u*)(WT + (size_t)(orow0 + n) * K + k0 + 8 * c) = o; }
    asm volatile("s_waitcnt lgkmcnt(0)" ::: "memory");
}
__device__ __forceinline__ void rms_row_to_bf16(const float* __restrict__ xrow, bf16* __restrict__ orow, int lane) {
    const f32x4* xr = (const f32x4*)xrow + lane;
    f32x4 v[4]; float s = 0.f;
#pragma unroll
    for (int j = 0; j < 4; ++j) { v[j] = xr[64 * j]; s += (v[j].x * v[j].x + v[j].y * v[j].y) + (v[j].z * v[j].z + v[j].w * v[j].w); }
    const float rstd = __builtin_amdgcn_rsqf(wave_sum(s) * (1.f / D) + 1e-6f);
    v2u* o8 = (v2u*)orow + lane;
#pragma unroll
    for (int j = 0; j < 4; ++j) { v2u w; w.x = cvtpk(v[j].x * rstd, v[j].y * rstd); w.y = cvtpk(v[j].z * rstd, v[j].w * rstd); o8[64 * j] = w; }
}
__device__ __forceinline__ void rms_row_final(float* xrow, const float* __restrict__ gain, int lane) {
    f32x4* xr = (f32x4*)xrow + lane; const f32x4* gr = (const f32x4*)gain + lane;
    f32x4 v[4]; float s = 0.f;
#pragma unroll
    for (int j = 0; j < 4; ++j) { v[j] = xr[64 * j]; s += (v[j].x * v[j].x + v[j].y * v[j].y) + (v[j].z * v[j].z + v[j].w * v[j].w); }
    const float rstd = __builtin_amdgcn_rsqf(wave_sum(s) * (1.f / D) + 1e-6f);
#pragma unroll
    for (int j = 0; j < 4; ++j) xr[64 * j] = v[j] * rstd * gr[64 * j];
}

namespace att {
constexpr int SLOTB = 32768, VBASE = 65536;
__device__ __forceinline__ unsigned swz(unsigned row) { return ((row & 3u) << 2) | ((row >> 2) & 3u); }
__device__ __forceinline__ s16x4 trd(const LAS unsigned char* p) { typedef short v4i16_t __attribute__((ext_vector_type(4)));
    return __builtin_bit_cast(s16x4, __builtin_amdgcn_ds_read_tr16_b64_v4i16((LAS v4i16_t*)p)); }

__device__ __forceinline__ void segment(LAS unsigned char* lds, const bf16* __restrict__ QKV, bf16* __restrict__ Og, float* __restrict__ L2, int bl, int g, int h, int r, int dil, int n0, int cnt, int tid) {
    const int lane = tid & 63, w = __builtin_amdgcn_readfirstlane(tid >> 6), lq = lane & 15, gq = lane >> 4;
    const size_t rowbase = (size_t)bl * SEQ + r;
    const bf16* qcol = QKV + (size_t)g * 3072 + h * 128;
    const int srow = tid >> 4, sch = tid & 15;
    const unsigned sdst = 256u * srow + 16u * ((unsigned)sch ^ swz(srow));
    unsigned koff[4], voff[8];
#pragma unroll
    for (int s = 0; s < 4; ++s) koff[s] = 256u * lq + 16u * ((unsigned)(4 * s + gq) ^ swz(lq));
    { const unsigned q4 = lq >> 2, p4 = lq & 3, rowv = 4 * gq + q4;
#pragma unroll
      for (int c = 0; c < 8; ++c) voff[c] = 256u * rowv + 16u * ((unsigned)(2 * c + (p4 >> 1)) ^ swz(rowv)) + 8u * (p4 & 1); }
    const float cb = exp2f(-8.0f * (float)(g * 8 + h + 1) / 24.0f) * (float)dil * 1.4426950408889634f;
    const float basel = -cb * (float)(128 + lq - 4 * gq);

    v4u kv[8]; bf16x8 qn[4], qf[4];
#define ATT_LOADKV(nn) do { const bf16* src_ = qcol + (rowbase + (size_t)(128 * (nn) + srow) * dil) * NQKV + 1024 + sch * 8; const size_t st_ = (size_t)32 * dil * NQKV; \
        _Pragma("unroll") for (int i_ = 0; i_ < 4; ++i_) { kv[i_] = *(const v4u*)(src_ + i_ * st_); kv[4 + i_] = *(const v4u*)(src_ + i_ * st_ + 1024); } } while (0)
#define ATT_LOADQ(nn) do { const bf16* src_ = qcol + (rowbase + (size_t)(128 * (nn) + 16 * w + lq) * dil) * NQKV + 8 * gq; \
        _Pragma("unroll") for (int s_ = 0; s_ < 4; ++s_) qn[s_] = *(const bf16x8*)(src_ + 32 * s_); } while (0)
#define ATT_WRITEKV(slot) do { LAS unsigned char* d_ = lds + (slot) * SLOTB + sdst; \
        _Pragma("unroll") for (int i_ = 0; i_ < 4; ++i_) { *(LAS v4u*)(d_ + 8192 * i_) = kv[i_]; *(LAS v4u*)(d_ + VBASE + 8192 * i_) = kv[4 + i_]; } } while (0)

    __syncthreads();
    if (n0 > 0) { ATT_LOADKV(n0 - 1); ATT_WRITEKV((n0 - 1) & 1); }
    else { const v4u z = {0u, 0u, 0u, 0u}; LAS unsigned char* d_ = lds + 1 * SLOTB + sdst;
#pragma unroll
        for (int i = 0; i < 4; ++i) { *(LAS v4u*)(d_ + 8192 * i) = z; *(LAS v4u*)(d_ + VBASE + 8192 * i) = z; } }
    ATT_LOADKV(n0); ATT_LOADQ(n0);
    for (int n = n0; n < n0 + cnt; ++n) {
        ATT_WRITEKV(n & 1);
#pragma unroll
        for (int s = 0; s < 4; ++s) qf[s] = qn[s];
        __syncthreads();
        if (n + 1 < n0 + cnt) { ATT_LOADKV(n + 1); ATT_LOADQ(n + 1); }
        const int cur = n & 1, prv = cur ^ 1;
        f32x4 sc[9];
#pragma unroll
        for (int kt = 0; kt < 9; ++kt) { const int tt = w + kt; const int slot = (tt >> 3) ? cur : prv;
            const LAS unsigned char* kb = lds + slot * SLOTB + (tt & 7) * 4096; f32x4 a = {0.f, 0.f, 0.f, 0.f};
#pragma unroll
            for (int s = 0; s < 4; ++s) a = __builtin_amdgcn_mfma_f32_16x16x32_bf16(*(const LAS bf16x8*)(kb + koff[s]), qf[s], a, 0, 0, 0);
            sc[kt] = a; }
        const bool firstblk = (n == 0);
        float mx = -INFINITY;
#pragma unroll
        for (int kt = 0; kt < 9; ++kt)
#pragma unroll
            for (int i = 0; i < 4; ++i) { float v = sc[kt][i] + (basel + cb * (float)(16 * kt + i)); bool valid = true;
                if (kt == 0) valid = (4 * gq + i >= lq);
                if (kt == 8) valid = (4 * gq + i <= lq);
                if (firstblk && (w + kt) < 8) valid = false;
                v = valid ? v : -INFINITY; sc[kt][i] = v; mx = fmaxf(mx, v); }
        mx = fmaxf(mx, __shfl_xor(mx, 16)); mx = fmaxf(mx, __shfl_xor(mx, 32));
        float den = 0.f; unsigned pk[9][2];
#pragma unroll
        for (int kt = 0; kt < 9; ++kt) { const float p0 = __builtin_amdgcn_exp2f(sc[kt][0] - mx), p1 = __builtin_amdgcn_exp2f(sc[kt][1] - mx), p2 = __builtin_amdgcn_exp2f(sc[kt][2] - mx), p3 = __builtin_amdgcn_exp2f(sc[kt][3] - mx);
            den += (p0 + p1) + (p2 + p3); pk[kt][0] = cvtpk(p0, p1); pk[kt][1] = cvtpk(p2, p3); }
        den += __shfl_xor(den, 16); den += __shfl_xor(den, 32);
        const float rden = __builtin_amdgcn_rcpf(den);
        const size_t orow = rowbase + (size_t)(128 * n + 16 * w + lq) * dil;
        bf16* op = Og + ((size_t)g * MH + orow) * 1024 + h * 128 + 4 * gq;
#pragma unroll
        for (int c = 0; c < 8; ++c) { f32x4 a = {0.f, 0.f, 0.f, 0.f};
#pragma unroll
            for (int ks = 0; ks < 4; ++ks) { const int t0 = w + 2 * ks, t1 = t0 + 1;
                const LAS unsigned char* v0p = lds + VBASE + ((t0 >> 3) ? cur : prv) * SLOTB + (t0 & 7) * 4096 + voff[c];
                const LAS unsigned char* v1p = lds + VBASE + ((t1 >> 3) ? cur : prv) * SLOTB + (t1 & 7) * 4096 + voff[c];
                const s16x4 v0 = trd(v0p), v1 = trd(v1p);
                const bf16x8 A = {v0[0], v0[1], v0[2], v0[3], v1[0], v1[1], v1[2], v1[3]};
                const v4u bw = {pk[2 * ks][0], pk[2 * ks][1], pk[2 * ks + 1][0], pk[2 * ks + 1][1]};
                a = __builtin_amdgcn_mfma_f32_16x16x32_bf16(A, __builtin_bit_cast(bf16x8, bw), a, 0, 0, 0); }
            { const int t8 = w + 8; const LAS unsigned char* v8p = lds + VBASE + cur * SLOTB + (t8 & 7) * 4096 + voff[c];
              const s16x4 v8 = trd(v8p); const v2u bw = {pk[8][0], pk[8][1]};
              a = __builtin_amdgcn_mfma_f32_16x16x16bf16_1k(v8, __builtin_bit_cast(s16x4, bw), a, 0, 0, 0); }
            v2u wv; wv.x = cvtpk(a[0] * rden, a[1] * rden); wv.y = cvtpk(a[2] * rden, a[3] * rden);
            *(v2u*)(op + 16 * c) = wv; }
        if (gq == 0) L2[((size_t)g * MH + orow) * 8 + h] = mx + __builtin_amdgcn_logf(den);
        __syncthreads();
    }
#undef ATT_LOADKV
#undef ATT_LOADQ
#undef ATT_WRITEKV
}

__device__ __forceinline__ void phase(LAS unsigned char* lds, const bf16* QKV, bf16* Og, float* L2, int tid) {
    for (int it = blockIdx.x; it < 768; it += gridDim.x) {
        const int g = it >> 8, idx = it & 255;
        int bl, h, r, dil, n0, cnt, nseg = 1;
        if (g == 0) { const int strip = idx >> 3; bl = strip >> 3; h = strip & 7; r = 0; dil = 1; n0 = 4 * (idx & 7); cnt = 4; }
        else if (g == 1) { const int strip = idx >> 1; bl = strip >> 5; h = (strip >> 2) & 7; r = strip & 3; dil = 4; n0 = 4 * (idx & 1); cnt = 4; }
        else { bl = idx >> 6; h = (idx >> 3) & 7; r = 2 * (idx & 7); dil = 16; n0 = 0; cnt = 2; nseg = 2; }
        for (int sg = 0; sg < nseg; ++sg) segment(lds, QKV, Og, L2, bl, g, h, r + sg, dil, n0, cnt, tid);
    }
    __syncthreads();
}
}

__device__ __forceinline__ void merge_half(const bf16* __restrict__ Og, const float* __restrict__ L2, bf16* __restrict__ O  , int gtid, int gthreads) {
    for (int idx = gtid; idx < MH * 128; idx += gthreads) {
        const int tl = idx >> 7, ch = idx & 127, h = ch >> 4;
        const float l0 = L2[((size_t)0 * MH + tl) * 8 + h], l1 = L2[((size_t)1 * MH + tl) * 8 + h], l2 = L2[((size_t)2 * MH + tl) * 8 + h];
        const float mx = fmaxf(l0, fmaxf(l1, l2));
        float w0 = __builtin_amdgcn_exp2f(l0 - mx), w1 = __builtin_amdgcn_exp2f(l1 - mx), w2 = __builtin_amdgcn_exp2f(l2 - mx);
        const float inv = __builtin_amdgcn_rcpf(w0 + w1 + w2); w0 *= inv; w1 *= inv; w2 *= inv;
        const v4u a = *(const v4u*)(Og + ((size_t)0 * MH + tl) * 1024 + ch * 8), b = *(const v4u*)(Og + ((size_t)1 * MH + tl) * 1024 + ch * 8), c = *(const v4u*)(Og + ((size_t)2 * MH + tl) * 1024 + ch * 8);
        v4u o;
#pragma unroll
        for (int j = 0; j < 4; ++j) o[j] = cvtpk(w0 * bflo(a[j]) + w1 * bflo(b[j]) + w2 * bflo(c[j]), w0 * bfhi(a[j]) + w1 * bfhi(b[j]) + w2 * bfhi(c[j]));
        *(v4u*)(O + (size_t)tl * 1024 + ch * 8) = o;
    }
}

__device__ __forceinline__ void pool_pass(const bf16* __restrict__ U, bf16* __restrict__ Y, int gtid, int gthreads) {
    for (int task = gtid; task < BATCH * 128 * 128; task += gthreads) {
        const int chg = task & 127, chunk = (task >> 7) & 127, b = task >> 14;
        const int w = 2 << (chg >> 5);
        const bf16* up = U + (size_t)b * SEQ * 1024 + chg * 8; bf16* yp = Y + (size_t)b * SEQ * 1024 + chg * 8;
        const int t0 = chunk * 32;
        float sum[8];
#pragma unroll
        for (int j = 0; j < 8; ++j) sum[j] = 0.f;
        for (int i = 1; i < w; ++i) { const int t = t0 - i; if (t >= 0) { const v4u v = *(const v4u*)(up + (size_t)t * 1024);
#pragma unroll
            for (int j = 0; j < 4; ++j) { sum[2 * j] += bflo(v[j]); sum[2 * j + 1] += bfhi(v[j]); } } }
#pragma unroll 4
        for (int t = t0; t < t0 + 32; ++t) {
            const v4u v = *(const v4u*)(up + (size_t)t * 1024);
            const int tb = t - w; v4u vb = {0u, 0u, 0u, 0u};
            if (t > t0 && tb >= 0) vb = *(const v4u*)(up + (size_t)tb * 1024);
            const float rc = 1.0f / (float)((t + 1 < w) ? (t + 1) : w);
            v4u o;
#pragma unroll
            for (int j = 0; j < 4; ++j) { const float c0 = bflo(v[j]), c1 = bfhi(v[j]);
                sum[2 * j] += c0 - bflo(vb[j]); sum[2 * j + 1] += c1 - bfhi(vb[j]);
                o[j] = cvtpk(sum[2 * j] * rc - c0, sum[2 * j + 1] * rc - c1); }
            *(v4u*)(yp + (size_t)t * 1024) = o;
        }
    }
}

struct Args { const float* in[12]; float* out; unsigned char* ws; int ph_lo, ph_hi; };
__global__ void __launch_bounds__(NTHREADS, 2) trunk_fwd(Args args) {
    extern __shared__ __attribute__((aligned(16))) unsigned char lds_raw[];
    LAS unsigned char* lds = (LAS unsigned char*)lds_raw;
    cg::grid_group grid = cg::this_grid();
    const int tid = threadIdx.x, lane = tid & 63, wave = __builtin_amdgcn_readfirstlane(tid >> 6);
    const int G = gridDim.x, bx = blockIdx.x;
    const int gw = bx * NWAVES + wave, NGW = G * NWAVES, gtid = bx * NTHREADS + tid, gthreads = G * NTHREADS;
    unsigned char* ws = args.ws;
    const float* x = args.in[0]; const float* attn_norm = args.in[1]; const float* w_qkv = args.in[2]; const float* w_attn_out = args.in[3];
    const float* pool_norm = args.in[4]; const float* w_pool_in = args.in[5]; const float* w_pool_group = args.in[6]; const float* pool_scale = args.in[7];
    const float* ffn_norm = args.in[8]; const float* w_gu = args.in[9]; const float* w_dn = args.in[10]; const float* final_norm = args.in[11];
    float* out = args.out;
    float* slots = (float*)(ws + WS_SLOTS); float* L2 = (float*)(ws + WS_LSE);
    bf16* Wqkv_t = (bf16*)(ws + WS_WQKV); bf16* Wout_t = (bf16*)(ws + WS_WOUT); bf16* Wpin_t = (bf16*)(ws + WS_WPIN); bf16* Wg_t = (bf16*)(ws + WS_WG);
    bf16* Wgu_t = (bf16*)(ws + WS_WGU); bf16* Wdn_t = (bf16*)(ws + WS_WDN);
    bf16* XN = (bf16*)(ws + WS_XN); bf16* QKV = (bf16*)(ws + WS_BIG); bf16* XB = (bf16*)(ws + WS_XB); bf16* HB = (bf16*)(ws + WS_H); bf16* YB = (bf16*)(ws + WS_Y);
    bf16* Og = (bf16*)out;
    const int lo = args.ph_lo, hi = args.ph_hi;
#define IN(k) (lo <= (k) && (k) < hi)
#define SEAM(k) do { if (IN(k) && IN((k) + 1)) grid.sync(); } while (0)

    if (IN(0)) {
        LAS float* scr = (LAS float*)(lds + wave * 16384);
        constexpr int I_QKV = 16 * 288, I_SQ = 16 * 32, I_G = 4 * 8, I_GU = 16 * 176, I_DN = 44 * 32;
        constexpr int NITEMS = I_QKV + 2 * I_SQ + 4 * I_G + 2 * I_GU + 2 * I_DN;
        for (int it = gw; it < NITEMS; it += NGW) {
            int r = it;
            if (r < I_QKV) { transpose_item(w_qkv, D, NQKV, Wqkv_t, attn_norm, 1, nullptr, scr, r, lane); continue; } r -= I_QKV;
            if (r < I_SQ) { transpose_item(w_attn_out, D, D, Wout_t, nullptr, 0, nullptr, scr, r, lane); continue; } r -= I_SQ;
            if (r < I_SQ) { transpose_item(w_pool_in, D, D, Wpin_t, pool_norm, 0, nullptr, scr, r, lane); continue; } r -= I_SQ;
            if (r < 4 * I_G) { const int gg = r / I_G; transpose_item(w_pool_group + (size_t)gg * 65536, 256, 256, Wg_t + (size_t)gg * 65536, nullptr, 3, pool_scale + 256 * gg, scr, r % I_G, lane); continue; } r -= 4 * I_G;
            if (r < 2 * I_GU) { const int l = r / I_GU; transpose_item(w_gu + (size_t)l * D * NGU, D, NGU, Wgu_t + (size_t)l * NGU * D, ffn_norm + l * D, 2, nullptr, scr, r % I_GU, lane); continue; } r -= 2 * I_GU;
            { const int l = r / I_DN; transpose_item(w_dn + (size_t)l * DFF * D, DFF, D, Wdn_t + (size_t)l * D * DFF, nullptr, 0, nullptr, scr, r % I_DN, lane); }
        }
        for (int m = gw; m < M; m += NGW) rms_row_to_bf16(x + (size_t)m * D, XN + (size_t)m * D, lane);
        __syncthreads();
    }
    SEAM(0);
    if (IN(1)) { pg8::Gemm g{XN, Wqkv_t, MH, NQKV, D, D, 0}; pg8::StaticOrder S; S.init(MH, NQKV, G, bx); pg8::EpiBf16S E{QKV, NQKV, nullptr};
        pg8::gemm_phase<pg8::EpiBf16S, pg8::StaticOrder, true, true>(lds, g, S, E); }
    SEAM(1);
    if (IN(2)) att::phase(lds, QKV, Og, L2, tid);
    SEAM(2);
    if (IN(3)) { merge_half(Og, L2, XN, gtid, gthreads);
        pg8::Gemm g{XN + (size_t)MH * D, Wqkv_t, MH, NQKV, D, D, 0}; pg8::StaticOrder S; S.init(MH, NQKV, G, bx); pg8::EpiBf16S E{QKV, NQKV, nullptr};
        pg8::gemm_phase<pg8::EpiBf16S, pg8::StaticOrder, true, true>(lds, g, S, E); }
    SEAM(3);
    if (IN(4)) att::phase(lds, QKV, Og, L2, tid);
    SEAM(4);
    if (IN(5)) merge_half(Og, L2, XN + (size_t)MH * D, gtid, gthreads);
    SEAM(5);
    if (IN(6)) { pg8::Gemm g{XN, Wout_t, M, D, D, D, 0}; pg8::StaticOrder S; S.init(M, D, G, bx); pg8::EpiRes E{x, out, XB, slots};
        pg8::gemm_phase<pg8::EpiRes, pg8::StaticOrder, true, true>(lds, g, S, E); }
    SEAM(6);
    if (IN(7)) { pg8::Gemm g{XB, Wgu_t, M, NGU, D, D, 0}; pg8::StaticOrder S; S.init(M, NGU, G, bx); pg8::EpiSwiGLU E{HB, DFF, slots};
        pg8::gemm_phase<pg8::EpiSwiGLU, pg8::StaticOrder, true, true>(lds, g, S, E); }
    SEAM(7);
    if (IN(8)) { pg8::Gemm g{HB, Wdn_t, M, D, DFF, DFF, 0}; pg8::StaticOrder S; S.init(M, D, G, bx); pg8::EpiRes E{out, out, XB, slots};
        pg8::gemm_phase<pg8::EpiRes, pg8::StaticOrder, true, true>(lds, g, S, E); }
    SEAM(8);
    if (IN(9)) { pg8::Gemm g{XB, Wpin_t, M, D, D, D, 0}; pg8::StaticOrder S; S.init(M, D, G, bx); pg8::EpiBf16S E{XN, D, slots};
        pg8::gemm_phase<pg8::EpiBf16S, pg8::StaticOrder, true, true>(lds, g, S, E); }
    SEAM(9);
    if (IN(10)) pool_pass(XN, YB, gtid, gthreads);
    SEAM(10);
    if (IN(11)) { pg8::Gemm g{YB, Wg_t, M, D, 256, D, 256}; pg8::StaticOrder S; S.init(M, D, G, bx); pg8::EpiRes E{out, out, XB, slots};
        pg8::gemm_phase<pg8::EpiRes, pg8::StaticOrder, true, true>(lds, g, S, E); }
    SEAM(11);
    if (IN(12)) { pg8::Gemm g{XB, Wgu_t + (size_t)NGU * D, M, NGU, D, D, 0}; pg8::StaticOrder S; S.init(M, NGU, G, bx); pg8::EpiSwiGLU E{HB, DFF, slots};
        pg8::gemm_phase<pg8::EpiSwiGLU, pg8::StaticOrder, true, true>(lds, g, S, E); }
    SEAM(12);
    if (IN(13)) { pg8::Gemm g{HB, Wdn_t + (size_t)D * DFF, M, D, DFF, DFF, 0}; pg8::StaticOrder S; S.init(M, D, G, bx); pg8::EpiRes E{out, out, nullptr, nullptr};
        pg8::gemm_phase<pg8::EpiRes, pg8::StaticOrder, true, true>(lds, g, S, E); }
    SEAM(13);
    if (IN(14)) for (int m = gw; m < M; m += NGW) rms_row_final(out + (size_t)m * D, final_norm, lane);
#undef IN
#undef SEAM
}

extern "C" void kernel_launch(void* const* d_in, const int* in_sizes, int n_in, void* d_out, int out_size, void* d_ws, size_t ws_size, hipStream_t stream) {
    static int grid = 0;
    if (grid == 0) {
        if (n_in != 12 || in_sizes[0] != M * D || out_size != M * D || ws_size < WS_END) { fprintf(stderr, "kernel_launch: unexpected shapes (n_in %d, in0 %d, out %d, ws %zu)\n", n_in, n_in > 0 ? in_sizes[0] : -1, out_size, ws_size); grid = -1; return; }
        int dev = 0, cus = 0, per_cu = 0;
        if (hipGetDevice(&dev) != hipSuccess || hipDeviceGetAttribute(&cus, hipDeviceAttributeMultiprocessorCount, dev) != hipSuccess) { grid = -1; return; }
        if (hipFuncSetAttribute((const void*)trunk_fwd, hipFuncAttributeMaxDynamicSharedMemorySize, LDS_BYTES) != hipSuccess) { fprintf(stderr, "kernel_launch: hipFuncSetAttribute failed\n"); grid = -1; return; }
        if (hipOccupancyMaxActiveBlocksPerMultiprocessor(&per_cu, (const void*)trunk_fwd, NTHREADS, LDS_BYTES) != hipSuccess || per_cu < 1) { fprintf(stderr, "kernel_launch: occupancy query says %d\n", per_cu); (void)hipGetLastError(); per_cu = 1; }
        grid = cus * 1;
        if (per_cu < 1) grid = -1;
    }
    if (grid < 0) return;
    Args a{};
    for (int i = 0; i < 12; ++i) a.in[i] = (const float*)d_in[i];
    a.out = (float*)d_out; a.ws = (unsigned char*)d_ws;
    constexpr int NL = MK_N_LAUNCHES;
    for (int li = 0; li < NL; ++li) {
        a.ph_lo = (NL == 1) ? 0 : li; a.ph_hi = (NL == 1) ? N_PHASES : li + 1;
        void* kargs[] = {&a};
        const hipError_t e = hipLaunchCooperativeKernel((const void*)trunk_fwd, dim3(grid), dim3(NTHREADS), kargs, LDS_BYTES, stream);
        if (e != hipSuccess) { fprintf(stderr, "kernel_launch: cooperative launch %d failed: %s (grid %d)\n", li, hipGetErrorString(e), grid); break; }
    }
}
```
